# Optimizing an MI355X kernel written in HIP

```python
import math
import jax, jax.numpy as jnp
from jax import lax
import numpy as np

D_MODEL = 1024
BATCH = 4
SEQ = 4096
DEPTH = 4

N_EVEN = (DEPTH + 1) // 2
N_ODD = DEPTH // 2

POOL_WINDOWS = (2, 4, 8, 16)
POOL_GROUPS = 4
POOL_WIDTH = D_MODEL // 2
POOL_GDIM = POOL_WIDTH // POOL_GROUPS
SGU_GROUPS = 4
SGU_WIDTH = D_MODEL // 2
SGU_GDIM = SGU_WIDTH // SGU_GROUPS
SGU_CHUNK = 128
EVEN_IN = POOL_WIDTH + 2 * SGU_WIDTH
EVEN_MIX = POOL_WIDTH + SGU_WIDTH
NSA_HEADS = 8
NSA_KV_GROUPS = 2
NSA_HPG = NSA_HEADS // NSA_KV_GROUPS
NSA_HEAD_DIM = 64
NSA_WIDTH = NSA_HEADS * NSA_HEAD_DIM
NSA_KV_WIDTH = NSA_KV_GROUPS * NSA_HEAD_DIM
CMP_BLOCK = 32
CMP_STRIDE = 16
CMP_HIDDEN = 128
SEL_BLOCK = 64
SEL_TOPK = 16
WINDOW = 512
Q_BLOCK = 128
FORCE_SCORE = 1.0e4
ROPE_THETA = 500000.0
ROPE_DIM = NSA_HEAD_DIM // 4
RET_HEADS = 4
RET_HEAD_DIM = 128
RET_WIDTH = RET_HEADS * RET_HEAD_DIM
RET_CHUNK = 128
RET_THETA = 10000.0
ODD_IN = NSA_WIDTH + 6 * NSA_KV_WIDTH + 3 * NSA_HEADS + 4 * RET_WIDTH
ODD_MIX = NSA_WIDTH + RET_WIDTH
FFN_HIDDEN = -(-8 * D_MODEL // (3 * 256)) * 256
NEG_INF = -1.0e30

kernel_name = "hybrid_pool_sgu_nsa_retention_trunk"


def rms_norm(x, g, eps=1e-6):
    xf = x.astype(jnp.float32)
    y = xf * lax.rsqrt(jnp.mean(xf * xf, axis=-1, keepdims=True) + eps)
    return (y * g.astype(jnp.float32)).astype(x.dtype)


def layer_norm(x, g, b, eps=1e-5):
    xf = x.astype(jnp.float32)
    mu = jnp.mean(xf, axis=-1, keepdims=True)
    var = jnp.mean(jnp.square(xf - mu), axis=-1, keepdims=True)
    return ((xf - mu) * lax.rsqrt(var + eps) * g.astype(jnp.float32) + b.astype(jnp.float32)).astype(x.dtype)


def masked_softmax(s, mask):
    return jax.nn.softmax(jnp.where(mask, s.astype(jnp.float32), NEG_INF), axis=-1)


def rope_tables(positions, rot_dim, theta):
    inv_freq = 1.0 / (theta ** (jnp.arange(0, rot_dim, 2, dtype=jnp.float32) / rot_dim))
    ang = positions.astype(jnp.float32)[..., None] * inv_freq
    return jnp.cos(ang)[:, None], jnp.sin(ang)[:, None]


def apply_rope(x, cos, sin):
    half = cos.shape[-1]
    x1, x2, rest = x[..., :half], x[..., half:2 * half], x[..., 2 * half:]
    c, s = cos.astype(x.dtype), sin.astype(x.dtype)
    return jnp.concatenate([x1 * c - x2 * s, x2 * c + x1 * s, rest], axis=-1)


def to_heads(x, n):
    b, t, _ = x.shape
    return x.reshape(b, t, n, -1).transpose(0, 2, 1, 3)


def swiglu(h, w_gate, w_up, w_down):
    return (jax.nn.silu(h @ w_gate) * (h @ w_up)) @ w_down


def pool_mixer(a, pool_w, pool_scale):
    b, t_len, _ = a.shape
    af = a.astype(jnp.float32).reshape(b, t_len, POOL_GROUPS, POOL_GDIM)
    cs = jnp.concatenate([jnp.zeros_like(af[:, :1]), jnp.cumsum(af, axis=1)], axis=1)
    t = jnp.arange(t_len)
    pooled = []
    for gi, w in enumerate(POOL_WINDOWS):
        lo = jnp.maximum(t + 1 - w, 0)
        win_sum = cs[:, 1:, gi] - cs[:, lo, gi]
        pooled.append(win_sum / (t + 1 - lo).astype(jnp.float32)[None, :, None])
    pooled = jnp.stack(pooled, axis=2)
    diff = (pooled - af).astype(a.dtype)
    y = jnp.einsum('btgc,gcd->btgd', diff, pool_w)
    return y.reshape(b, t_len, POOL_WIDTH) * pool_scale


def sgu_mixer(u, v, ln_g, ln_b, w_s, b_s):
    b, t_len, _ = u.shape
    u = jax.nn.gelu(u)
    v = layer_norm(jax.nn.gelu(v), ln_g, ln_b)
    n_chunk = t_len // SGU_CHUNK
    vc = v.reshape(b, n_chunk, SGU_CHUNK, SGU_GROUPS, SGU_GDIM)
    causal = jnp.tril(jnp.ones((SGU_CHUNK, SGU_CHUNK), dtype=bool))
    w_masked = jnp.where(causal[None], w_s, 0.0).astype(v.dtype)
    mixed = jnp.einsum('gts,bcsgd->bctgd', w_masked, vc) + b_s.T[None, None, :, :, None]
    return u * mixed.reshape(b, t_len, SGU_WIDTH)


def even_mixer(h, w_in, pool_w, pool_scale, sgu_ln_g, sgu_ln_b, sgu_w, sgu_b, w_out):
    z = h @ w_in
    a = z[..., :POOL_WIDTH]
    u = z[..., POOL_WIDTH:POOL_WIDTH + SGU_WIDTH]
    v = z[..., POOL_WIDTH + SGU_WIDTH:]
    y_a = pool_mixer(a, pool_w, pool_scale)
    y_b = sgu_mixer(u, v, sgu_ln_g, sgu_ln_b, sgu_w, sgu_b)
    return jnp.concatenate([y_a, y_b], axis=-1) @ w_out


def compress_blocks(k, pos_emb, w1, w2):
    t_len = k.shape[2]
    n_cmp = (t_len - CMP_BLOCK) // CMP_STRIDE + 1
    idx = np.arange(n_cmp)[:, None] * CMP_STRIDE + np.arange(CMP_BLOCK)[None, :]
    blocks = k[:, :, idx] + pos_emb
    flat = blocks.reshape(blocks.shape[:3] + (CMP_BLOCK * NSA_HEAD_DIM,))
    return jax.nn.gelu(flat @ w1) @ w2


def nsa_attention(q, k_cmp, v_cmp, k_sel, v_sel, k_win, v_win, gates, positions,
                  cmp_k_pos, cmp_k_w1, cmp_k_w2, cmp_v_pos, cmp_v_w1, cmp_v_w2):
    b, t_len, _ = q.shape
    G, M, d = NSA_KV_GROUPS, NSA_HPG, NSA_HEAD_DIM
    cos, sin = rope_tables(positions, ROPE_DIM, ROPE_THETA)
    q = apply_rope(to_heads(q, NSA_HEADS), cos, sin) * (d ** -0.5)
    k_cmp = apply_rope(to_heads(k_cmp, G), cos, sin)
    k_sel = apply_rope(to_heads(k_sel, G), cos, sin)
    k_win = apply_rope(to_heads(k_win, G), cos, sin)
    v_cmp, v_sel, v_win = to_heads(v_cmp, G), to_heads(v_sel, G), to_heads(v_win, G)

    kc = compress_blocks(k_cmp, cmp_k_pos, cmp_k_w1, cmp_k_w2)
    vc = compress_blocks(v_cmp, cmp_v_pos, cmp_v_w1, cmp_v_w2)
    n_cmp = kc.shape[2]
    cmp_end = jnp.arange(n_cmp) * CMP_STRIDE + CMP_BLOCK - 1

    n_sel = t_len // SEL_BLOCK
    top_k = min(SEL_TOPK, n_sel)
    c_start = np.arange(n_cmp) * CMP_STRIDE
    s_start = np.arange(n_sel) * SEL_BLOCK
    cmp_to_sel = ((c_start[:, None] < s_start[None, :] + SEL_BLOCK)
                  & (c_start[:, None] + CMP_BLOCK > s_start[None, :])).astype(np.float32)
    ks_blk = k_sel.reshape(b, G, n_sel, SEL_BLOCK, d)
    vs_blk = v_sel.reshape(b, G, n_sel, SEL_BLOCK, d)
    kw_pad = jnp.pad(k_win, ((0, 0), (0, 0), (WINDOW, 0), (0, 0)))
    vw_pad = jnp.pad(v_win, ((0, 0), (0, 0), (WINDOW, 0), (0, 0)))
    g = jax.nn.sigmoid(gates.astype(jnp.float32)).reshape(b, t_len, NSA_HEADS, 3)
    g = g.transpose(0, 2, 1, 3).astype(q.dtype)
    b_idx = jnp.arange(b)[:, None, None, None]
    g_idx = jnp.arange(G)[None, :, None, None]
    j_sel = jnp.arange(n_sel)

    def block(i):
        t0 = i * Q_BLOCK
        tq = t0 + jnp.arange(Q_BLOCK)
        qb = lax.dynamic_slice_in_dim(q, t0, Q_BLOCK, axis=2).reshape(b, G, M, Q_BLOCK, d)
        gb = lax.dynamic_slice_in_dim(g, t0, Q_BLOCK, axis=2)
        s = jnp.einsum('bgmqd,bgnd->bgmqn', qb, kc)
        p_cmp = masked_softmax(s, cmp_end[None, :] <= tq[:, None])
        p_cmp = p_cmp * (tq >= CMP_BLOCK - 1).astype(jnp.float32)[:, None]
        o_cmp = jnp.einsum('bgmqn,bgnd->bgmqd', p_cmp.astype(vc.dtype), vc)
        p_slc = jnp.einsum('bgmqn,nj->bgqj', p_cmp, cmp_to_sel)
        cur = tq // SEL_BLOCK
        sel_ok = j_sel[None, :] <= cur[:, None]
        forced = (j_sel[None, :] == 0) | (j_sel[None, :] == cur[:, None]) | (j_sel[None, :] == cur[:, None] - 1)
        score = jnp.where(sel_ok, jnp.where(forced, FORCE_SCORE, p_slc), -1.0)
        top_val, top_idx = lax.top_k(score, top_k)
        ks = ks_blk[b_idx, g_idx, top_idx]
        vs = vs_blk[b_idx, g_idx, top_idx]
        tok = top_idx[..., None] * SEL_BLOCK + jnp.arange(SEL_BLOCK)
        tok_ok = (top_val >= 0.0)[..., None] & (tok <= tq[:, None, None])
        s = jnp.einsum('bgmqd,bgqkld->bgmqkl', qb, ks).reshape(b, G, M, Q_BLOCK, top_k * SEL_BLOCK)
        p = masked_softmax(s, tok_ok.reshape(b, G, 1, Q_BLOCK, top_k * SEL_BLOCK))
        p = p.reshape(b, G, M, Q_BLOCK, top_k, SEL_BLOCK).astype(vs.dtype)
        o_sel = jnp.einsum('bgmqkl,bgqkld->bgmqd', p, vs)
        kwb = lax.dynamic_slice_in_dim(kw_pad, t0, WINDOW + Q_BLOCK, axis=2)
        vwb = lax.dynamic_slice_in_dim(vw_pad, t0, WINDOW + Q_BLOCK, axis=2)
        pos = t0 - WINDOW + jnp.arange(WINDOW + Q_BLOCK)
        win_ok = (pos[None, :] >= 0) & (pos[None, :] <= tq[:, None]) & (pos[None, :] > tq[:, None] - WINDOW)
        s = jnp.einsum('bgmqd,bgsd->bgmqs', qb, kwb)
        o_win = jnp.einsum('bgmqs,bgsd->bgmqd', masked_softmax(s, win_ok).astype(vwb.dtype), vwb)
        o = jnp.stack([o_cmp, o_sel, o_win], axis=-1).reshape(b, NSA_HEADS, Q_BLOCK, d, 3)
        return jnp.einsum('bhqdc,bhqc->bqhd', o, gb)

    out = lax.map(block, jnp.arange(t_len // Q_BLOCK))
    return out.transpose(1, 0, 2, 3, 4).reshape(b, t_len, NSA_WIDTH)


def retention(q, k, v, gate, positions, gn_g):
    b, t_len, _ = q.shape
    H, d, C = RET_HEADS, RET_HEAD_DIM, RET_CHUNK
    n_chunk = t_len // C
    cos, sin = rope_tables(positions, d, RET_THETA)
    q = apply_rope(to_heads(q, H), cos, sin)
    k = apply_rope(to_heads(k, H), cos, sin) * (d ** -0.5)
    v = to_heads(v, H)
    log_gamma = jnp.log1p(-jnp.exp2(-5.0 - jnp.arange(H, dtype=jnp.float32)))
    idx = jnp.arange(C, dtype=jnp.float32)
    rel = idx[:, None] - idx[None, :]
    decay = jnp.where(rel >= 0, jnp.exp(jnp.maximum(rel, 0.0)[None] * log_gamma[:, None, None]), 0.0)
    qc = q.reshape(b, H, n_chunk, C, d)
    kc = k.reshape(b, H, n_chunk, C, d)
    vc = v.reshape(b, H, n_chunk, C, d)
    s = jnp.einsum('bhcid,bhcjd->bhcij', qc, kc) * decay[None, :, None].astype(q.dtype)
    o_intra = jnp.einsum('bhcij,bhcje->bhcie', s, vc)
    zeta = jnp.exp((C - 1 - idx)[None, :] * log_gamma[:, None])
    chunk_kv = jnp.einsum('bhcjd,bhcje->bhcde', kc * zeta[None, :, None, :, None].astype(k.dtype), vc)
    g_chunk = jnp.exp(C * log_gamma)[None, :, None, None]

    def step(state, kv):
        return state * g_chunk + kv, state

    _, prev = lax.scan(step, jnp.zeros((b, H, d, d), jnp.float32),
                       jnp.moveaxis(chunk_kv, 2, 0).astype(jnp.float32))
    prev = jnp.moveaxis(prev, 0, 2)
    xi = jnp.exp((idx + 1.0)[None, :] * log_gamma[:, None])
    o_cross = jnp.einsum('bhcid,bhcde->bhcie', qc.astype(jnp.float32) * xi[None, :, None, :, None], prev)
    o = (o_intra.astype(jnp.float32) + o_cross).reshape(b, H, t_len, d).transpose(0, 2, 1, 3)
    mu = jnp.mean(o, axis=-1, keepdims=True)
    var = jnp.mean(jnp.square(o - mu), axis=-1, keepdims=True)
    o = ((o - mu) * lax.rsqrt(var + 1e-5)).reshape(b, t_len, RET_WIDTH) * gn_g.astype(jnp.float32)
    return (jax.nn.silu(gate.astype(jnp.float32)) * o).astype(gate.dtype)


def odd_mixer(h, positions, w_in, cmp_k_pos, cmp_k_w1, cmp_k_w2, cmp_v_pos, cmp_v_w1, cmp_v_w2,
              ret_gn_g, w_out):
    z = h @ w_in
    sizes = [NSA_WIDTH] + [NSA_KV_WIDTH] * 6 + [3 * NSA_HEADS] + [RET_WIDTH] * 4
    splits = np.cumsum(sizes)[:-1].tolist()
    q, kc, vc, ks, vs, kw, vw, gt, rq, rk, rv, rg = jnp.split(z, splits, axis=-1)
    y_c = nsa_attention(q, kc, vc, ks, vs, kw, vw, gt, positions,
                        cmp_k_pos, cmp_k_w1, cmp_k_w2, cmp_v_pos, cmp_v_w1, cmp_v_w2)
    y_d = retention(rq, rk, rv, rg, positions, ret_gn_g)
    return jnp.concatenate([y_c, y_d], axis=-1) @ w_out


def setup_inputs(seed: int = 0) -> dict:
    key = jax.random.key(seed)
    ks = jax.random.split(key, 32)

    def nrm(k, shape, scale):
        return jax.random.normal(k, shape, jnp.float32) * scale

    def gain(k, shape):
        return 1.0 + 0.05 * jax.random.normal(k, shape, jnp.float32)

    NE, NO, D, F = N_EVEN, N_ODD, D_MODEL, FFN_HIDDEN
    x = nrm(ks[0], (BATCH, SEQ, D), 1.0)
    start = jax.random.randint(ks[1], (BATCH, 1), 0, 2048, dtype=jnp.int32)
    positions = start + jnp.arange(SEQ, dtype=jnp.int32)[None, :]
    cmp_in = CMP_BLOCK * NSA_HEAD_DIM
    return {
        "x": x,
        "positions": positions,
        "ln_mix_pre": gain(ks[2], (DEPTH, D)),
        "ln_mix_post": gain(ks[3], (DEPTH, D)),
        "ln_ffn_pre": gain(ks[4], (DEPTH, D)),
        "ln_ffn_post": gain(ks[5], (DEPTH, D)),
        "ffn_w_gate": nrm(ks[6], (DEPTH, D, F), D ** -0.5),
        "ffn_w_up": nrm(ks[7], (DEPTH, D, F), D ** -0.5),
        "ffn_w_down": nrm(ks[8], (DEPTH, F, D), F ** -0.5),
        "ev_w_in": nrm(ks[9], (NE, D, EVEN_IN), D ** -0.5),
        "ev_pool_w": nrm(ks[10], (NE, POOL_GROUPS, POOL_GDIM, POOL_GDIM), POOL_GDIM ** -0.5),
        "ev_pool_scale": 1.0 + 0.1 * jax.random.normal(ks[11], (NE, POOL_WIDTH), jnp.float32),
        "ev_sgu_ln_g": gain(ks[12], (NE, SGU_WIDTH)),
        "ev_sgu_ln_b": nrm(ks[13], (NE, SGU_WIDTH), 0.02),
        "ev_sgu_w": nrm(ks[14], (NE, SGU_GROUPS, SGU_CHUNK, SGU_CHUNK), SGU_CHUNK ** -0.5),
        "ev_sgu_b": 1.0 + 0.1 * jax.random.normal(ks[15], (NE, SGU_GROUPS, SGU_CHUNK), jnp.float32),
        "ev_w_out": nrm(ks[16], (NE, EVEN_MIX, D), EVEN_MIX ** -0.5),
        "od_w_in": nrm(ks[17], (NO, D, ODD_IN), D ** -0.5),
        "od_cmp_k_pos": nrm(ks[18], (NO, CMP_BLOCK, NSA_HEAD_DIM), 0.1),
        "od_cmp_k_w1": nrm(ks[19], (NO, cmp_in, CMP_HIDDEN), cmp_in ** -0.5),
        "od_cmp_k_w2": nrm(ks[20], (NO, CMP_HIDDEN, NSA_HEAD_DIM), CMP_HIDDEN ** -0.5),
        "od_cmp_v_pos": nrm(ks[21], (NO, CMP_BLOCK, NSA_HEAD_DIM), 0.1),
        "od_cmp_v_w1": nrm(ks[22], (NO, cmp_in, CMP_HIDDEN), cmp_in ** -0.5),
        "od_cmp_v_w2": nrm(ks[23], (NO, CMP_HIDDEN, NSA_HEAD_DIM), CMP_HIDDEN ** -0.5),
        "od_ret_gn_g": gain(ks[24], (NO, RET_WIDTH)),
        "od_w_out": nrm(ks[25], (NO, ODD_MIX, D), ODD_MIX ** -0.5),
    }


def reference(x, positions, ln_mix_pre, ln_mix_post, ln_ffn_pre, ln_ffn_post,
              ffn_w_gate, ffn_w_up, ffn_w_down,
              ev_w_in, ev_pool_w, ev_pool_scale, ev_sgu_ln_g, ev_sgu_ln_b, ev_sgu_w, ev_sgu_b, ev_w_out,
              od_w_in, od_cmp_k_pos, od_cmp_k_w1, od_cmp_k_w2, od_cmp_v_pos, od_cmp_v_w1, od_cmp_v_w2,
              od_ret_gn_g, od_w_out):
    for layer in range(DEPTH):
        h = rms_norm(x, ln_mix_pre[layer])
        if layer % 2 == 0:
            e = layer // 2
            m = even_mixer(h, ev_w_in[e], ev_pool_w[e], ev_pool_scale[e], ev_sgu_ln_g[e],
                           ev_sgu_ln_b[e], ev_sgu_w[e], ev_sgu_b[e], ev_w_out[e])
        else:
            o = layer // 2
            m = odd_mixer(h, positions, od_w_in[o], od_cmp_k_pos[o], od_cmp_k_w1[o], od_cmp_k_w2[o],
                          od_cmp_v_pos[o], od_cmp_v_w1[o], od_cmp_v_w2[o], od_ret_gn_g[o], od_w_out[o])
        x = x + rms_norm(m, ln_mix_post[layer])
        h = rms_norm(x, ln_ffn_pre[layer])
        x = x + rms_norm(swiglu(h, ffn_w_gate[layer], ffn_w_up[layer], ffn_w_down[layer]), ln_ffn_post[layer])
    return x
```

```cpp
#include <hip/hip_runtime.h>
#include <cstdio>
#include <cstdint>
#include <cmath>
namespace gold {
constexpr int T = 4096, D = 1024, F = 2816, NB = 4;
constexpr int EVEN_IN = 1536, ODD_IN = 3352;

__device__ __forceinline__ float wsum(float v) {
#pragma unroll
    for (int o = 1; o < 64; o <<= 1) v += __shfl_xor(v, o);
    return v;
}
__device__ __forceinline__ float wmax(float v) {
#pragma unroll
    for (int o = 1; o < 64; o <<= 1) v = fmaxf(v, __shfl_xor(v, o));
    return v;
}
__device__ __forceinline__ float gelu_tanh(float x) {
    const float k = 0.7978845608028654f;
    return 0.5f * x * (1.0f + tanhf(k * (x + 0.044715f * x * x * x)));
}
__device__ __forceinline__ float sigmoidf_(float x) { return 1.0f / (1.0f + expf(-x)); }

__global__ void k_rmsnorm(const float* x, const float* g, float* out, int rows, int ncols) {
    const int row = blockIdx.x * 4 + (threadIdx.x >> 6), lane = threadIdx.x & 63;
    if (row >= rows) return;
    const float* xr = x + (size_t)row * ncols; float s = 0.f;
    for (int c = lane; c < ncols; c += 64) { float v = xr[c]; s += v * v; }
    s = wsum(s);
    const float r = 1.0f / sqrtf(s / ncols + 1e-6f);
    for (int c = lane; c < ncols; c += 64) out[(size_t)row * ncols + c] = xr[c] * r * g[c];
}
__global__ void k_add_rmsnorm(float* x, const float* m, const float* g, int rows, int ncols) {
    const int row = blockIdx.x * 4 + (threadIdx.x >> 6), lane = threadIdx.x & 63;
    if (row >= rows) return;
    const float* mr = m + (size_t)row * ncols; float s = 0.f;
    for (int c = lane; c < ncols; c += 64) { float v = mr[c]; s += v * v; }
    s = wsum(s);
    const float r = 1.0f / sqrtf(s / ncols + 1e-6f);
    for (int c = lane; c < ncols; c += 64) x[(size_t)row * ncols + c] += mr[c] * r * g[c];
}
__global__ void __launch_bounds__(256) k_sgemm(const float* A, int lda, const float* B, int ldb, float* C, int ldc, int M, int N, int K) {
    __shared__ float As[16][65];
    __shared__ float Bs[16][65];
    const int tx = threadIdx.x & 15, ty = threadIdx.x >> 4;
    const int m0 = blockIdx.y * 64, n0 = blockIdx.x * 64;
    float acc[4][4] = {};
    for (int k0 = 0; k0 < K; k0 += 16) {
#pragma unroll
        for (int i = 0; i < 4; ++i) { const int e = threadIdx.x + i * 256; const int r = e >> 4, kk = e & 15; const int gm = m0 + r;
            As[kk][r] = (gm < M) ? A[(size_t)gm * lda + k0 + kk] : 0.f; }
#pragma unroll
        for (int i = 0; i < 4; ++i) { const int e = threadIdx.x + i * 256; const int kk = e >> 6, c = e & 63; const int gn = n0 + c;
            Bs[kk][c] = (gn < N) ? B[(size_t)(k0 + kk) * ldb + gn] : 0.f; }
        __syncthreads();
#pragma unroll
        for (int kk = 0; kk < 16; ++kk) {
            float a[4], b[4];
#pragma unroll
            for (int i = 0; i < 4; ++i) { a[i] = As[kk][ty * 4 + i]; b[i] = Bs[kk][tx * 4 + i]; }
#pragma unroll
            for (int i = 0; i < 4; ++i)
#pragma unroll
                for (int j = 0; j < 4; ++j) acc[i][j] += a[i] * b[j];
        }
        __syncthreads();
    }
#pragma unroll
    for (int i = 0; i < 4; ++i) { const int gm = m0 + ty * 4 + i; if (gm >= M) continue;
#pragma unroll
        for (int j = 0; j < 4; ++j) { const int gn = n0 + tx * 4 + j; if (gn < N) C[(size_t)gm * ldc + gn] = acc[i][j]; } }
}
inline void sgemm(hipStream_t st, const float* A, int lda, const float* B, int ldb, float* C, int ldc, int M, int N, int K) {
    dim3 grid((N + 63) / 64, (M + 63) / 64);
    hipLaunchKernelGGL(k_sgemm, grid, dim3(256), 0, st, A, lda, B, ldb, C, ldc, M, N, K);
}
__global__ void k_swiglu(const float* G, const float* U, float* out, size_t n) {
    size_t i = (size_t)blockIdx.x * 256 + threadIdx.x; if (i >= n) return;
    const float g = G[i]; out[i] = g * sigmoidf_(g) * U[i];
}
__global__ void k_pool_diff(const float* Z, int ldz, float* DIFF) {
    const int t = blockIdx.x, ch = threadIdx.x + blockIdx.y * 256;
    const int gi = ch >> 7, w = 2 << gi;
    int lo = t + 1 - w; if (lo < 0) lo = 0;
    float s = 0.f;
    for (int p = lo; p <= t; ++p) s += Z[(size_t)p * ldz + ch];
    DIFF[(size_t)t * 512 + ch] = s / (float)(t + 1 - lo) - Z[(size_t)t * ldz + ch];
}
__global__ void k_colscale(float* Y, int ldy, const float* scale, int ncols) {
    const int t = blockIdx.x; for (int c = threadIdx.x; c < ncols; c += 256) Y[(size_t)t * ldy + c] *= scale[c];
}
__global__ void k_sgu_prep(const float* Z, int ldz, const float* lng, const float* lnb, float* U, float* V) {
    const int t = blockIdx.x, tid = threadIdx.x;
    __shared__ float red[8];
    const float* zu = Z + (size_t)t * ldz + 512; const float* zv = Z + (size_t)t * ldz + 1024;
    float v0 = gelu_tanh(zv[tid]), v1 = gelu_tanh(zv[tid + 256]);
    U[(size_t)t * 512 + tid] = gelu_tanh(zu[tid]); U[(size_t)t * 512 + tid + 256] = gelu_tanh(zu[tid + 256]);
    float s = wsum(v0 + v1); if ((tid & 63) == 0) red[tid >> 6] = s; __syncthreads();
    const float mu = (red[0] + red[1] + red[2] + red[3]) / 512.f; __syncthreads();
    const float d0 = v0 - mu, d1 = v1 - mu;
    float q = wsum(d0 * d0 + d1 * d1); if ((tid & 63) == 0) red[tid >> 6] = q; __syncthreads();
    const float var = (red[0] + red[1] + red[2] + red[3]) / 512.f;
    const float r = 1.0f / sqrtf(var + 1e-5f);
    V[(size_t)t * 512 + tid] = d0 * r * lng[tid] + lnb[tid];
    V[(size_t)t * 512 + tid + 256] = d1 * r * lng[tid + 256] + lnb[tid + 256];
}
__global__ void k_sgu_mix(const float* U, const float* V, const float* W, const float* bs, float* MIX) {
    const int t = blockIdx.x, g = blockIdx.y, d = threadIdx.x;
    const int c = t >> 7, tt = t & 127;
    const float* w = W + ((size_t)g * 128 + tt) * 128;
    float acc = 0.f;
    for (int s = 0; s <= tt; ++s) acc += w[s] * V[(size_t)(c * 128 + s) * 512 + g * 128 + d];
    acc += bs[g * 128 + tt];
    MIX[(size_t)t * 1024 + 512 + g * 128 + d] = U[(size_t)t * 512 + g * 128 + d] * acc;
}
__global__ void k_rope_table(const int* pos, float* cosb, float* sinb, int half, float theta) {
    const int t = blockIdx.x, i = threadIdx.x; if (i >= half) return;
    const float e = (float)(2 * i) / (float)(2 * half);
    const float inv = 1.0f / powf(theta, e);
    const float ang = (float)pos[t] * inv;
    cosb[(size_t)t * half + i] = cosf(ang); sinb[(size_t)t * half + i] = sinf(ang);
}
__global__ void k_rope_apply(const float* in, int ldin, int off, float* out, int ldo, int hd, int half, const float* cosb, const float* sinb, float scale) {
    const int t = blockIdx.x, h = blockIdx.y, d = threadIdx.x;
    const float* x = in + (size_t)t * ldin + off + h * hd;
    float v;
    if (d < half) v = x[d] * cosb[(size_t)t * half + d] - x[d + half] * sinb[(size_t)t * half + d];
    else if (d < 2 * half) v = x[d] * cosb[(size_t)t * half + d - half] + x[d - half] * sinb[(size_t)t * half + d - half];
    else v = x[d];
    out[(size_t)t * ldo + h * hd + d] = v * scale;
}
__global__ void k_cmp_hidden(const float* k, int ldk, const float* pos, const float* w1, float* HID) {
    const int n = blockIdx.x, g = blockIdx.y, j = threadIdx.x;
    float acc = 0.f;
    for (int l = 0; l < 32; ++l) for (int d = 0; d < 64; ++d)
        acc += (k[(size_t)(16 * n + l) * ldk + g * 64 + d] + pos[l * 64 + d]) * w1[(size_t)(l * 64 + d) * 128 + j];
    HID[((size_t)g * 255 + n) * 128 + j] = gelu_tanh(acc);
}
__global__ void k_cmp_out(const float* HID, const float* w2, float* OUT) {
    const int n = blockIdx.x, g = blockIdx.y, d = threadIdx.x;
    float acc = 0.f;
    for (int j = 0; j < 128; ++j) acc += HID[((size_t)g * 255 + n) * 128 + j] * w2[j * 64 + d];
    OUT[((size_t)g * 255 + n) * 64 + d] = acc;
}
__global__ void __launch_bounds__(256) k_nsa_attn(const float* Q, const float* KS, const float* VS, int ldvs, const float* KW, const float* VW, int ldvw,
                                                const float* KC, const float* VC, const float* gates, int ldg, float* MIX) {
    const int t = blockIdx.x, g = blockIdx.y, m = threadIdx.x >> 6, lane = threadIdx.x & 63, h = g * 4 + m;
    __shared__ float qs[4][64];
    __shared__ float sc[4][1024];
    __shared__ float score[64];
    __shared__ int selidx[16];
    __shared__ int nsel_s;
    qs[m][lane] = Q[(size_t)t * 512 + h * 64 + lane];
    for (int n = lane; n < 256; n += 64) sc[m][n] = 0.f;
    __syncthreads();
    int nvalid = (t >= 31) ? ((t - 31) / 16 + 1) : 0; if (nvalid > 255) nvalid = 255;
    float o_cmp = 0.f;
    if (nvalid > 0) {
        float mx = -INFINITY;
        for (int n = lane; n < nvalid; n += 64) { const float* kr = KC + ((size_t)g * 255 + n) * 64; float s = 0.f;
            for (int d = 0; d < 64; ++d) s += qs[m][d] * kr[d];
            sc[m][n] = s; mx = fmaxf(mx, s); }
        mx = wmax(mx); float sum = 0.f;
        for (int n = lane; n < nvalid; n += 64) { const float e = expf(sc[m][n] - mx); sc[m][n] = e; sum += e; }
        sum = wsum(sum); const float inv = 1.0f / sum;
        for (int n = lane; n < nvalid; n += 64) sc[m][n] *= inv;
        __builtin_amdgcn_s_waitcnt(0);
        for (int n = 0; n < nvalid; ++n) o_cmp += sc[m][n] * VC[((size_t)g * 255 + n) * 64 + lane];
    }
    __syncthreads();
    const int cur = t >> 6;
    if (threadIdx.x < 64) {
        const int j = threadIdx.x; float ps = 0.f;
        for (int mm = 0; mm < 4; ++mm) for (int n = 4 * j - 1; n <= 4 * j + 3; ++n) if (n >= 0 && n < 255) ps += sc[mm][n];
        const bool ok = j <= cur, forced = (j == 0) || (j == cur) || (j == cur - 1);
        score[j] = ok ? (forced ? 1.0e4f : ps) : -1.0f;
    }
    __syncthreads();
    if (threadIdx.x < 64) {
        const int j = threadIdx.x; const float sj = score[j]; int rank = 0;
        for (int i = 0; i < 64; ++i) { const float si = score[i]; if (si > sj || (si == sj && i < j)) ++rank; }
        const bool sel = (rank < 16) && (sj >= 0.f);
        const unsigned long long mask = __ballot(sel);
        if (sel) { const int ord = __popcll(mask & ((1ull << j) - 1ull)); selidx[ord] = j; }
        if (j == 0) nsel_s = __popcll(mask);
    }
    __syncthreads();
    const int nsel = nsel_s;
    float o_sel = 0.f;
    {
        float mx = -INFINITY;
        for (int i = 0; i < nsel; ++i) { const int tok = selidx[i] * 64 + lane; float s = -INFINITY;
            if (tok <= t) { const float* kr = KS + (size_t)tok * 128 + g * 64; s = 0.f; for (int d = 0; d < 64; ++d) s += qs[m][d] * kr[d]; }
            sc[m][i * 64 + lane] = s; mx = fmaxf(mx, s); }
        mx = wmax(mx); float sum = 0.f;
        for (int i = 0; i < nsel; ++i) { const float s = sc[m][i * 64 + lane]; const float e = (s == -INFINITY) ? 0.f : expf(s - mx); sc[m][i * 64 + lane] = e; sum += e; }
        sum = wsum(sum); const float inv = 1.0f / sum;
        __builtin_amdgcn_s_waitcnt(0);
        for (int i = 0; i < nsel; ++i) for (int l = 0; l < 64; ++l) { const float p = sc[m][i * 64 + l]; if (p != 0.f) { const int tok = selidx[i] * 64 + l; o_sel += p * VS[(size_t)tok * ldvs + g * 64 + lane]; } }
        o_sel *= inv;
    }
    float o_win = 0.f;
    {
        float mx = -INFINITY;
        for (int i = 0; i < 8; ++i) { const int pos = t - 511 + i * 64 + lane; float s = -INFINITY;
            if (pos >= 0) { const float* kr = KW + (size_t)pos * 128 + g * 64; s = 0.f; for (int d = 0; d < 64; ++d) s += qs[m][d] * kr[d]; }
            sc[m][i * 64 + lane] = s; mx = fmaxf(mx, s); }
        mx = wmax(mx); float sum = 0.f;
        for (int i = 0; i < 8; ++i) { const float s = sc[m][i * 64 + lane]; const float e = (s == -INFINITY) ? 0.f : expf(s - mx); sc[m][i * 64 + lane] = e; sum += e; }
        sum = wsum(sum); const float inv = 1.0f / sum;
        __builtin_amdgcn_s_waitcnt(0);
        for (int sidx = 0; sidx < 512; ++sidx) { const float p = sc[m][sidx]; if (p != 0.f) { const int pos = t - 511 + sidx; o_win += p * VW[(size_t)pos * ldvw + g * 64 + lane]; } }
        o_win *= inv;
    }
    const float* gt = gates + (size_t)t * ldg + h * 3;
    const float g0 = sigmoidf_(gt[0]), g1 = sigmoidf_(gt[1]), g2 = sigmoidf_(gt[2]);
    MIX[(size_t)t * 1024 + h * 64 + lane] = g0 * o_cmp + g1 * o_sel + g2 * o_win;
}
__device__ __forceinline__ float log_gamma(int h) { return log1pf(-exp2f(-5.0f - (float)h)); }
__global__ void k_ret_kv(const float* RK, const float* V, int ldv, float* KV) {
    const int c = blockIdx.x, h = blockIdx.y, d = blockIdx.z, e = threadIdx.x;
    const float lg = log_gamma(h); float acc = 0.f;
    for (int j = 0; j < 128; ++j) { const int t = c * 128 + j; acc += RK[(size_t)t * 512 + h * 128 + d] * expf((float)(127 - j) * lg) * V[(size_t)t * ldv + h * 128 + e]; }
    KV[(((size_t)h * 32 + c) * 128 + d) * 128 + e] = acc;
}
__global__ void k_ret_scan(float* KV) {
    const int h = blockIdx.y; const int de = blockIdx.x * 256 + threadIdx.x;
    const float gch = expf(128.0f * log_gamma(h)); float state = 0.f;
    for (int c = 0; c < 32; ++c) { float* p = KV + ((size_t)h * 32 + c) * 16384 + de; const float kv = *p; *p = state; state = state * gch + kv; }
}
__global__ void __launch_bounds__(256) k_ret_out(const float* RQ, const float* RK, const float* V, int ldv, const float* PREV, const float* gate, int ldgate, const float* gn, float* MIX) {
    const int c = blockIdx.x, h = blockIdx.y, tid = threadIdx.x;
    extern __shared__ float S[];
    const float lg = log_gamma(h);
    for (int idx = tid; idx < 128 * 128; idx += 256) { const int i = idx >> 7, j = idx & 127; float s = 0.f;
        if (j <= i) { const float* q = RQ + (size_t)(c * 128 + i) * 512 + h * 128; const float* k = RK + (size_t)(c * 128 + j) * 512 + h * 128;
            for (int d = 0; d < 128; ++d) s += q[d] * k[d];
            s *= expf((float)(i - j) * lg); }
        S[i * 129 + j] = s; }
    __syncthreads();
    const int wv = tid >> 6, lane = tid & 63;
    for (int i = wv; i < 128; i += 4) {
        float o0 = 0.f, o1 = 0.f; const int t = c * 128 + i;
        for (int j = 0; j <= i; ++j) { const float s = S[i * 129 + j]; const float* vr = V + (size_t)(c * 128 + j) * ldv + h * 128; o0 += s * vr[lane]; o1 += s * vr[lane + 64]; }
        const float xi = expf((float)(i + 1) * lg); const float* q = RQ + (size_t)t * 512 + h * 128; const float* pv = PREV + ((size_t)h * 32 + c) * 16384;
        float c0 = 0.f, c1 = 0.f;
        for (int d = 0; d < 128; ++d) { const float qd = q[d] * xi; c0 += qd * pv[d * 128 + lane]; c1 += qd * pv[d * 128 + lane + 64]; }
        o0 += c0; o1 += c1;
        const float mu = wsum(o0 + o1) / 128.f; const float d0 = o0 - mu, d1 = o1 - mu;
        const float var = wsum(d0 * d0 + d1 * d1) / 128.f; const float r = 1.0f / sqrtf(var + 1e-5f);
        const float* gt = gate + (size_t)t * ldgate + h * 128; const float ga = gt[lane], gb = gt[lane + 64];
        MIX[(size_t)t * 1024 + 512 + h * 128 + lane] = ga * sigmoidf_(ga) * d0 * r * gn[h * 128 + lane];
        MIX[(size_t)t * 1024 + 512 + h * 128 + lane + 64] = gb * sigmoidf_(gb) * d1 * r * gn[h * 128 + lane + 64];
    }
}

struct Bufs { float *H, *Z, *MIX, *MO, *Z2, *S1, *S2, *S3; };
inline size_t ws_floats() { return (size_t)T * (1024 + 3352 + 1024 + 1024 + 2816) + (size_t)T * (512 + 512 + 128 * 3 + 512 * 2) + 4 * 255 * 128 * 2 + 4 * 255 * 64 * 2 + (size_t)4 * 32 * 16384 + T * (8 + 8 + 64 + 64) + 4096; }

inline void forward(void* const* d_in, float* xout, float* ws, hipStream_t st) {
    const float* x_in = (const float*)d_in[0]; const int* positions = (const int*)d_in[1];
    const float *ln_mix_pre = (const float*)d_in[2], *ln_mix_post = (const float*)d_in[3], *ln_ffn_pre = (const float*)d_in[4], *ln_ffn_post = (const float*)d_in[5];
    const float *wg = (const float*)d_in[6], *wu = (const float*)d_in[7], *wd = (const float*)d_in[8];
    const float *ev_w_in = (const float*)d_in[9], *ev_pool_w = (const float*)d_in[10], *ev_pool_scale = (const float*)d_in[11], *ev_ln_g = (const float*)d_in[12], *ev_ln_b = (const float*)d_in[13],
                *ev_sgu_w = (const float*)d_in[14], *ev_sgu_b = (const float*)d_in[15], *ev_w_out = (const float*)d_in[16];
    const float *od_w_in = (const float*)d_in[17], *kpos = (const float*)d_in[18], *kw1 = (const float*)d_in[19], *kw2 = (const float*)d_in[20], *vpos = (const float*)d_in[21], *vw1 = (const float*)d_in[22],
                *vw2 = (const float*)d_in[23], *gn_g = (const float*)d_in[24], *od_w_out = (const float*)d_in[25];
    float* p = ws;
    float* H = p; p += (size_t)T * 1024; float* Z = p; p += (size_t)T * 3352; float* MIX = p; p += (size_t)T * 1024; float* MO = p; p += (size_t)T * 1024; float* Z2 = p; p += (size_t)T * 2816;
    float* DIFF = p; p += (size_t)T * 512;
    float* UU = p; p += (size_t)T * 512;
    float* VV = p; p += (size_t)T * 512;
    float* KCr = p; p += (size_t)T * 128; float* KSr = p; p += (size_t)T * 128; float* KWr = p; p += (size_t)T * 128;
    float* HIDk = p; p += 2 * 255 * 128; float* HIDv = p; p += 2 * 255 * 128; float* KC = p; p += 2 * 255 * 64; float* VC = p; p += 2 * 255 * 64;
    float* KV = p; p += (size_t)4 * 32 * 16384;
    float* cos8 = p; p += T * 8; float* sin8 = p; p += T * 8; float* cos64 = p; p += T * 64; float* sin64 = p; p += T * 64;
    (void)hipMemcpyAsync(xout, x_in, (size_t)NB * T * D * 4, hipMemcpyDeviceToDevice, st);
    (void)hipFuncSetAttribute((const void*)k_ret_out, hipFuncAttributeMaxDynamicSharedMemorySize, 128 * 129 * 4);
    for (int b = 0; b < NB; ++b) {
        float* x = xout + (size_t)b * T * D;
        const int* pos = positions + (size_t)b * T;
        hipLaunchKernelGGL(k_rope_table, dim3(T), dim3(64), 0, st, pos, cos8, sin8, 8, 500000.0f);
        hipLaunchKernelGGL(k_rope_table, dim3(T), dim3(64), 0, st, pos, cos64, sin64, 64, 10000.0f);
        for (int L = 0; L < 4; ++L) {
            hipLaunchKernelGGL(k_rmsnorm, dim3(T / 4), dim3(256), 0, st, x, ln_mix_pre + L * D, H, T, D);
            if ((L & 1) == 0) {
                const int e = L / 2;
                sgemm(st, H, D, ev_w_in + (size_t)e * D * EVEN_IN, EVEN_IN, Z, EVEN_IN, T, EVEN_IN, D);
                hipLaunchKernelGGL(k_pool_diff, dim3(T, 2), dim3(256), 0, st, Z, EVEN_IN, DIFF);
                for (int gi = 0; gi < 4; ++gi) sgemm(st, DIFF + gi * 128, 512, ev_pool_w + ((size_t)e * 4 + gi) * 128 * 128, 128, MIX + gi * 128, 1024, T, 128, 128);
                hipLaunchKernelGGL(k_colscale, dim3(T), dim3(256), 0, st, MIX, 1024, ev_pool_scale + e * 512, 512);
                hipLaunchKernelGGL(k_sgu_prep, dim3(T), dim3(256), 0, st, Z, EVEN_IN, ev_ln_g + e * 512, ev_ln_b + e * 512, UU, VV);
                hipLaunchKernelGGL(k_sgu_mix, dim3(T, 4), dim3(128), 0, st, UU, VV, ev_sgu_w + (size_t)e * 4 * 128 * 128, ev_sgu_b + e * 4 * 128, MIX);
                sgemm(st, MIX, 1024, ev_w_out + (size_t)e * 1024 * 1024, 1024, MO, 1024, T, 1024, 1024);
            } else {
                const int o = L / 2;
                sgemm(st, H, D, od_w_in + (size_t)o * D * ODD_IN, ODD_IN, Z, ODD_IN, T, ODD_IN, D);
                float* Q = DIFF; float* RQ = UU; float* RK = VV;
                hipLaunchKernelGGL(k_rope_apply, dim3(T, 8), dim3(64), 0, st, Z, ODD_IN, 0, Q, 512, 64, 8, cos8, sin8, 0.125f);
                hipLaunchKernelGGL(k_rope_apply, dim3(T, 2), dim3(64), 0, st, Z, ODD_IN, 512, KCr, 128, 64, 8, cos8, sin8, 1.0f);
                hipLaunchKernelGGL(k_rope_apply, dim3(T, 2), dim3(64), 0, st, Z, ODD_IN, 768, KSr, 128, 64, 8, cos8, sin8, 1.0f);
                hipLaunchKernelGGL(k_rope_apply, dim3(T, 2), dim3(64), 0, st, Z, ODD_IN, 1024, KWr, 128, 64, 8, cos8, sin8, 1.0f);
                hipLaunchKernelGGL(k_cmp_hidden, dim3(255, 2), dim3(128), 0, st, KCr, 128, kpos + o * 2048, kw1 + (size_t)o * 2048 * 128, HIDk);
                hipLaunchKernelGGL(k_cmp_hidden, dim3(255, 2), dim3(128), 0, st, Z + 640, ODD_IN, vpos + o * 2048, vw1 + (size_t)o * 2048 * 128, HIDv);
                hipLaunchKernelGGL(k_cmp_out, dim3(255, 2), dim3(64), 0, st, HIDk, kw2 + o * 128 * 64, KC);
                hipLaunchKernelGGL(k_cmp_out, dim3(255, 2), dim3(64), 0, st, HIDv, vw2 + o * 128 * 64, VC);
                hipLaunchKernelGGL(k_nsa_attn, dim3(T, 2), dim3(256), 0, st, Q, KSr, Z + 896, ODD_IN, KWr, Z + 1152, ODD_IN, KC, VC, Z + 1280, ODD_IN, MIX);
                hipLaunchKernelGGL(k_rope_apply, dim3(T, 4), dim3(128), 0, st, Z, ODD_IN, 1304, RQ, 512, 128, 64, cos64, sin64, 1.0f);
                hipLaunchKernelGGL(k_rope_apply, dim3(T, 4), dim3(128), 0, st, Z, ODD_IN, 1816, RK, 512, 128, 64, cos64, sin64, 0.08838834764831845f);
                hipLaunchKernelGGL(k_ret_kv, dim3(32, 4, 128), dim3(128), 0, st, RK, Z + 2328, ODD_IN, KV);
                hipLaunchKernelGGL(k_ret_scan, dim3(64, 4), dim3(256), 0, st, KV);
                hipLaunchKernelGGL(k_ret_out, dim3(32, 4), dim3(256), 128 * 129 * 4, st, RQ, RK, Z + 2328, ODD_IN, KV, Z + 2840, ODD_IN, gn_g + o * 512, MIX);
                sgemm(st, MIX, 1024, od_w_out + (size_t)o * 1024 * 1024, 1024, MO, 1024, T, 1024, 1024);
            }
            hipLaunchKernelGGL(k_add_rmsnorm, dim3(T / 4), dim3(256), 0, st, x, MO, ln_mix_post + L * D, T, D);
            hipLaunchKernelGGL(k_rmsnorm, dim3(T / 4), dim3(256), 0, st, x, ln_ffn_pre + L * D, H, T, D);
            sgemm(st, H, D, wg + (size_t)L * D * F, F, Z, F, T, F, D);
            sgemm(st, H, D, wu + (size_t)L * D * F, F, Z2, F, T, F, D);
            hipLaunchKernelGGL(k_swiglu, dim3((unsigned)(((size_t)T * F + 255) / 256)), dim3(256), 0, st, Z, Z2, Z, (size_t)T * F);
            sgemm(st, Z, F, wd + (size_t)L * F * D, D, MO, D, T, D, F);
            hipLaunchKernelGGL(k_add_rmsnorm, dim3(T / 4), dim3(256), 0, st, x, MO, ln_ffn_post + L * D, T, D);
        }
    }
}
}
extern "C" void kernel_launch(void* const* d_in, const int* in_sizes, int n_in, void* d_out, int out_size, void* d_ws, size_t ws_size, hipStream_t stream) {
    if (n_in != 26 || out_size != 4 * 4096 * 1024 || ws_size < gold::ws_floats() * 4) { fprintf(stderr, "kernel_launch: unexpected sizes n_in %d out %d ws %zu\n", n_in, out_size, ws_size); return; }
    gold::forward(d_in, (float*)d_out, (float*)d_ws, stream);
}
```
